# Optimizing an MI355X kernel written in HIP

```python
import jax, jax.numpy as jnp
from jax import lax
import numpy as np

D_MODEL = 1024
BATCH = 8
SEQ = 4096
DEPTH = 2

CHUNK = 64
N_MIXERS = 2
N_MLSTM = (DEPTH + 1) // 2
N_RGLRU = DEPTH // 2

ML_HEADS = 8
ML_QK_DIM = D_MODEL // 2 // ML_HEADS
ML_V_DIM = D_MODEL // ML_HEADS
ML_QK = ML_HEADS * ML_QK_DIM
ML_V = ML_HEADS * ML_V_DIM
ML_IN = 2 * ML_QK + 2 * ML_V + 2 * ML_HEADS
GATE_CAP = 15.0
ML_M_INIT = -1e30

LRU_WIDTH = D_MODEL
LRU_BLOCKS = 4
LRU_BLOCK = LRU_WIDTH // LRU_BLOCKS
CONV_WIDTH = 4
LRU_C = 8.0

_FF_RAW = -(-8 * D_MODEL // 3)
D_FF = -(-_FF_RAW // 256) * 256

EPS = 1e-6

kernel_name = "hybrid_mlstm_rglru_trunk"


def rms_norm(x, g):
    xf = x.astype(jnp.float32)
    y = xf * lax.rsqrt(jnp.mean(xf * xf, axis=-1, keepdims=True) + EPS)
    return (y * g.astype(jnp.float32)).astype(x.dtype)


def soft_cap(z):
    return GATE_CAP * jnp.tanh(z / GATE_CAP)


def mlstm_mixer(x, w_in, b_if, head_norm, w_out):
    B, S, _ = x.shape
    H, dk, dv, L = ML_HEADS, ML_QK_DIM, ML_V_DIM, CHUNK
    NC = S // L
    proj = x @ w_in
    q, k, v, o, g = jnp.split(proj, [ML_QK, 2 * ML_QK, 2 * ML_QK + ML_V, 2 * ML_QK + 2 * ML_V], axis=-1)
    g = soft_cap(g.astype(jnp.float32) + b_if.astype(jnp.float32))
    log_i = g[..., :H]
    log_f = jax.nn.log_sigmoid(g[..., H:])

    def to_chunks(t, d):
        return t.astype(jnp.float32).reshape(B, NC, L, H, d).transpose(1, 0, 3, 2, 4)

    qc = to_chunks(q, dk) * (dk ** -0.5)
    kc = to_chunks(k, dk)
    vc = to_chunks(v, dv)
    li = log_i.reshape(B, NC, L, H).transpose(1, 0, 3, 2)
    lf = log_f.reshape(B, NC, L, H).transpose(1, 0, 3, 2)
    causal = jnp.tril(jnp.ones((L, L), dtype=bool))

    def step(carry, inp):
        C, n, m = carry
        qb, kb, vb, lib, lfb = inp
        b = jnp.cumsum(lfb, axis=-1)
        D = b[..., :, None] - b[..., None, :] + lib[..., None, :]
        D = jnp.where(causal, D, -jnp.inf)
        inter = b + m[..., None]
        m_t = jnp.maximum(jnp.max(D, axis=-1), inter)
        P = jnp.exp(D - m_t[..., None]) * jnp.einsum('bhld,bhsd->bhls', qb, kb)
        w_inter = jnp.exp(inter - m_t)
        num = jnp.einsum('bhls,bhsv->bhlv', P, vb) + w_inter[..., None] * jnp.einsum('bhld,bhdv->bhlv', qb, C)
        den = jnp.sum(P, axis=-1) + w_inter * jnp.einsum('bhld,bhd->bhl', qb, n)
        den = jnp.maximum(jnp.abs(den), jnp.exp(-m_t))
        h = num / den[..., None]
        g_tot = b[..., -1]
        a = g_tot[..., None] - b + lib
        m_new = jnp.maximum(g_tot + m, jnp.max(a, axis=-1))
        decay = jnp.exp(g_tot + m - m_new)
        wk = jnp.exp(a - m_new[..., None])[..., None] * kb
        C_new = decay[..., None, None] * C + jnp.einsum('bhsd,bhsv->bhdv', wk, vb)
        n_new = decay[..., None] * n + jnp.sum(wk, axis=2)
        return (C_new, n_new, m_new), h

    carry0 = (jnp.zeros((B, H, dk, dv), jnp.float32),
              jnp.zeros((B, H, dk), jnp.float32),
              jnp.full((B, H), ML_M_INIT, jnp.float32))
    _, hs = lax.scan(step, carry0, (qc, kc, vc, li, lf))
    hs = hs.transpose(1, 0, 3, 2, 4).reshape(B, S, H, dv)
    hs = hs * lax.rsqrt(jnp.mean(hs * hs, axis=-1, keepdims=True) + EPS)
    hs = hs * head_norm.astype(jnp.float32).reshape(H, dv)
    y = hs.reshape(B, S, ML_V) * jax.nn.sigmoid(o.astype(jnp.float32))
    return y.astype(x.dtype) @ w_out


def causal_depthwise_conv(u, w, bias):
    C = u.shape[-1]
    out = lax.conv_general_dilated(
        u, w[:, None, :].astype(u.dtype), window_strides=(1,), padding=[(CONV_WIDTH - 1, 0)],
        dimension_numbers=('NWC', 'WIO', 'NWC'), feature_group_count=C)
    return out + bias.astype(u.dtype)


def rglru_mixer(x, w_in, conv_w, conv_b, w_gate_a, b_gate_a, w_gate_x, b_gate_x, lam, w_out):
    B, S, _ = x.shape
    proj = x @ w_in
    gate_branch, u = proj[..., :LRU_WIDTH], proj[..., LRU_WIDTH:]
    u = causal_depthwise_conv(u, conv_w, conv_b)
    ub = u.reshape(B, S, LRU_BLOCKS, LRU_BLOCK)
    r = jax.nn.sigmoid((jnp.einsum('bsnc,ncd->bsnd', ub, w_gate_a).reshape(B, S, LRU_WIDTH)
                        + b_gate_a).astype(jnp.float32))
    i = jax.nn.sigmoid((jnp.einsum('bsnc,ncd->bsnd', ub, w_gate_x).reshape(B, S, LRU_WIDTH)
                        + b_gate_x).astype(jnp.float32))
    log_a = LRU_C * r * jax.nn.log_sigmoid(lam.astype(jnp.float32))
    a = jnp.exp(log_a)
    mult = jnp.sqrt(-jnp.expm1(2.0 * log_a))
    b = mult * i * u.astype(jnp.float32)

    def combine(lhs, rhs):
        a1, b1 = lhs
        a2, b2 = rhs
        return a1 * a2, a2 * b1 + b2

    _, h = lax.associative_scan(combine, (a, b), axis=1)
    y = h * jax.nn.gelu(gate_branch.astype(jnp.float32))
    return y.astype(x.dtype) @ w_out


def swiglu(x, w_gate, w_up, w_down):
    return (jax.nn.silu(x @ w_gate) * (x @ w_up)) @ w_down


def setup_inputs(seed: int = 0) -> dict:
    key = jax.random.key(seed)
    ks = jax.random.split(key, 24)
    f32 = jnp.float32

    def nrm(k, shape, fan_in):
        return jax.random.normal(k, shape, f32) * (fan_in ** -0.5)

    def gain(k, shape):
        return 1.0 + 0.05 * jax.random.normal(k, shape, f32)

    x = jax.random.normal(ks[0], (BATCH, SEQ, D_MODEL), f32)
    ml_w_in = nrm(ks[1], (N_MLSTM, D_MODEL, ML_IN), D_MODEL)
    b_i = 0.1 * jax.random.normal(ks[2], (N_MLSTM, ML_HEADS), f32)
    b_f = 3.0 + 3.0 * jax.random.uniform(ks[3], (N_MLSTM, ML_HEADS), f32)
    ml_b_if = jnp.concatenate([b_i, b_f], axis=-1)
    ml_head_norm = gain(ks[4], (N_MLSTM, ML_V))
    ml_w_out = nrm(ks[5], (N_MLSTM, ML_V, D_MODEL), ML_V)
    lru_w_in = nrm(ks[6], (N_RGLRU, D_MODEL, 2 * LRU_WIDTH), D_MODEL)
    lru_conv_w = nrm(ks[7], (N_RGLRU, CONV_WIDTH, LRU_WIDTH), CONV_WIDTH)
    lru_conv_b = 0.02 * jax.random.normal(ks[8], (N_RGLRU, LRU_WIDTH), f32)
    lru_w_gate_a = nrm(ks[9], (N_RGLRU, LRU_BLOCKS, LRU_BLOCK, LRU_BLOCK), LRU_BLOCK)
    lru_b_gate_a = 0.02 * jax.random.normal(ks[10], (N_RGLRU, LRU_WIDTH), f32)
    lru_w_gate_x = nrm(ks[11], (N_RGLRU, LRU_BLOCKS, LRU_BLOCK, LRU_BLOCK), LRU_BLOCK)
    lru_b_gate_x = 0.02 * jax.random.normal(ks[12], (N_RGLRU, LRU_WIDTH), f32)
    u = jax.random.uniform(ks[13], (N_RGLRU, LRU_WIDTH), f32, minval=0.9, maxval=0.999)
    lru_lambda = jnp.log(u) - jnp.log1p(-u)
    lru_w_out = nrm(ks[14], (N_RGLRU, LRU_WIDTH, D_MODEL), LRU_WIDTH)
    norm_pre_mix = gain(ks[15], (DEPTH, D_MODEL))
    norm_post_mix = gain(ks[16], (DEPTH, D_MODEL))
    norm_pre_ffn = gain(ks[17], (DEPTH, D_MODEL))
    norm_post_ffn = gain(ks[18], (DEPTH, D_MODEL))
    ffn_w_gate = nrm(ks[19], (DEPTH, D_MODEL, D_FF), D_MODEL)
    ffn_w_up = nrm(ks[20], (DEPTH, D_MODEL, D_FF), D_MODEL)
    ffn_w_down = nrm(ks[21], (DEPTH, D_FF, D_MODEL), D_FF)
    return {
        "x": x,
        "ml_w_in": ml_w_in, "ml_b_if": ml_b_if, "ml_head_norm": ml_head_norm, "ml_w_out": ml_w_out,
        "lru_w_in": lru_w_in, "lru_conv_w": lru_conv_w, "lru_conv_b": lru_conv_b,
        "lru_w_gate_a": lru_w_gate_a, "lru_b_gate_a": lru_b_gate_a,
        "lru_w_gate_x": lru_w_gate_x, "lru_b_gate_x": lru_b_gate_x,
        "lru_lambda": lru_lambda, "lru_w_out": lru_w_out,
        "norm_pre_mix": norm_pre_mix, "norm_post_mix": norm_post_mix,
        "norm_pre_ffn": norm_pre_ffn, "norm_post_ffn": norm_post_ffn,
        "ffn_w_gate": ffn_w_gate, "ffn_w_up": ffn_w_up, "ffn_w_down": ffn_w_down,
    }


def reference(x, ml_w_in, ml_b_if, ml_head_norm, ml_w_out,
              lru_w_in, lru_conv_w, lru_conv_b, lru_w_gate_a, lru_b_gate_a,
              lru_w_gate_x, lru_b_gate_x, lru_lambda, lru_w_out,
              norm_pre_mix, norm_post_mix, norm_pre_ffn, norm_post_ffn,
              ffn_w_gate, ffn_w_up, ffn_w_down):
    h = x
    for layer in range(DEPTH):
        j = layer // N_MIXERS
        y = rms_norm(h, norm_pre_mix[layer])
        if layer % N_MIXERS == 0:
            y = mlstm_mixer(y, ml_w_in[j], ml_b_if[j], ml_head_norm[j], ml_w_out[j])
        else:
            y = rglru_mixer(y, lru_w_in[j], lru_conv_w[j], lru_conv_b[j],
                            lru_w_gate_a[j], lru_b_gate_a[j], lru_w_gate_x[j], lru_b_gate_x[j],
                            lru_lambda[j], lru_w_out[j])
        h = h + rms_norm(y, norm_post_mix[layer])
        y = swiglu(rms_norm(h, norm_pre_ffn[layer]), ffn_w_gate[layer], ffn_w_up[layer], ffn_w_down[layer])
        h = h + rms_norm(y, norm_post_ffn[layer])
    return h
```

```cpp
#include <hip/hip_runtime.h>
#include <hip/hip_cooperative_groups.h>
#include <cstdio>
#include <cstdint>
namespace cg = cooperative_groups;

#ifndef PHMASK
#define PHMASK 0xFFFF
#endif
#ifndef MK_ONE_LAUNCH
#define MK_ONE_LAUNCH 0
#endif

#define LAS __attribute__((address_space(3)))
typedef unsigned short bf16_t;
typedef short bf16x8 __attribute__((ext_vector_type(8)));
typedef short s16x4 __attribute__((ext_vector_type(4)));
typedef float f32x4 __attribute__((ext_vector_type(4)));
typedef float f32x2 __attribute__((ext_vector_type(2)));
typedef unsigned u32x4 __attribute__((ext_vector_type(4)));
typedef unsigned u32x2 __attribute__((ext_vector_type(2)));

constexpr int BATCH = 8, SEQ = 4096, D = 1024, M = BATCH * SEQ;
constexpr int NQKVO = 3072;
constexpr int QOFF = 0, KOFF = 512, VOFF = 1024, OOFF = 2048;
constexpr int FF = 2816, NGU = 2 * FF;
constexpr int NUNIT = BATCH * 8 * 64;
constexpr float EPS = 1e-6f;

constexpr size_t MiB = 1u << 20;
constexpr size_t WS_WQKVO = 1 * MiB, WS_WG = 7 * MiB, WS_WMLO = 8 * MiB, WS_WLIN = 10 * MiB, WS_WLG = 14 * MiB, WS_WLO = 15 * MiB, WS_WGU = 17 * MiB, WS_WD = 39 * MiB;
constexpr size_t WS_GATES = 50 * MiB;
constexpr size_t WS_NL = 52 * MiB;
constexpr size_t WS_STAT = 53 * MiB;
constexpr size_t WS_AGGA = 54 * MiB, WS_AGGH = 56 * MiB;
constexpr size_t WS_LSL = 58 * MiB;
constexpr size_t WS_XN = 64 * MiB;
constexpr size_t WS_RA = 128 * MiB;
constexpr size_t WS_UC = 192 * MiB;
constexpr size_t WS_U = 256 * MiB;
constexpr size_t WS_LA = 256 * MiB;
constexpr size_t WS_LB = 384 * MiB;
constexpr size_t WS_CT = 320 * MiB;
constexpr size_t WS_Y = 384 * MiB;
constexpr size_t WS_OUT = 448 * MiB;
constexpr size_t WS_END = 512 * MiB;

constexpr int NWAVES = 8, NTHREADS = 512;
constexpr int LDS_BYTES = 147456;

typedef __bf16 bf16x2_t __attribute__((ext_vector_type(2)));
__device__ __forceinline__ unsigned cvt_pk_bf16(float lo, float hi) { const f32x2 v = {lo, hi}; const bf16x2_t b = __builtin_convertvector(v, bf16x2_t); return __builtin_bit_cast(unsigned, b); }
__device__ __forceinline__ float bf2f(unsigned short b) { return __uint_as_float(((unsigned)b) << 16); }
__device__ __forceinline__ float bflo(unsigned w) { return __uint_as_float(w << 16); }
__device__ __forceinline__ float bfhi(unsigned w) { return __uint_as_float(w & 0xffff0000u); }
__device__ __forceinline__ float wave_sum(float v) {
#pragma unroll
    for (int o = 1; o < 64; o <<= 1) v += __shfl_xor(v, o);
    return v;
}
__device__ __forceinline__ float wave_max(float v) {
#pragma unroll
    for (int o = 1; o < 64; o <<= 1) v = fmaxf(v, __shfl_xor(v, o));
    return v;
}
__device__ __forceinline__ float fast_rcp(float x) { return __builtin_amdgcn_rcpf(x); }
__device__ __forceinline__ float sigmoid_f(float x) { return fast_rcp(1.0f + __expf(-x)); }
__device__ __forceinline__ float gelu_tanh(float x) { const float t = 1.5957691216f * (x + 0.044715f * x * x * x); return x * fast_rcp(1.0f + __expf(-t)); }
__device__ __forceinline__ float log_sigmoid_f(float x) { return fminf(x, 0.f) - log1pf(expf(-fabsf(x))); }

namespace pg8 {
constexpr int BM = 256, BK = 64, HALF = 128, HTB = HALF * BK * 2, STAGE_BYTES = 8 * HTB, NXCD = 8, WGM = 8;
__host__ __device__ __forceinline__ int lds_byte(int r, int c) { const int st = (r >> 4) * 2 + (c >> 5), rr = r & 15, cc = c & 31, ob = rr * 64 + cc * 2; return st * 1024 + (ob ^ (((ob >> 9) & 1) << 5)); }
__host__ __device__ __forceinline__ void stage_rc(int b, int& R, int& C) { const int st = b / 1024, sb = b % 1024, swz = sb ^ (((sb >> 9) & 1) << 5); R = (st >> 1) * 16 + swz / 64; C = (st & 1) * 32 + (swz % 64) / 2; }
__host__ __device__ __forceinline__ int perm32(int rho) { const int n = rho >> 4, i = rho & 15; return 8 * (i >> 2) + 4 * n + (i & 3); }

struct Unit { int pm, pn; };
struct Gemm { const bf16_t* A; const bf16_t* Bt; int M, N, K, lda, ldb, ablk; };

struct StaticOrder {
    int nM, nN, nwg, G, c;
    __host__ __device__ void init(int M_, int N_, int G_, int c_) { nM = M_ / BM; nN = N_ / BM; nwg = nM * nN; G = G_; c = c_; }
    __host__ __device__ bool next(int i, Unit& u) const {
        const long L = (long)i * G + c; if (L >= nwg) return false;
        int wgid = (int)L; { const int q = nwg / NXCD, r = nwg % NXCD, xcd = wgid % NXCD, off = wgid / NXCD; wgid = (xcd < r ? xcd * (q + 1) : r * (q + 1) + (xcd - r) * q) + off; }
        const int nig = WGM * nN, gid = wgid / nig, fm = gid * WGM, gsz = (nM - fm) < WGM ? (nM - fm) : WGM;
        u.pm = fm + ((wgid % nig) % gsz); u.pn = (wgid % nig) / gsz; return true;
    }
    __device__ __forceinline__ void a_ready(const Unit&) const {}
    __device__ __forceinline__ void done(const Unit&) const {}
};

struct EpiBf16 {
    static constexpr bool PERM = true;
    bf16_t* O; int ldc;
    __device__ __forceinline__ void operator()(const f32x4 (&acc)[2][2][4][2], const Unit& u, int wr, int wc, int fr, int fq) const {
        const int row0 = u.pm * BM + wr * 64 + fr, col0 = u.pn * BM + wc * 32 + 8 * fq;
#pragma unroll
        for (int ai = 0; ai < 2; ++ai)
#pragma unroll
            for (int m = 0; m < 4; ++m) { bf16_t* rowp = O + (size_t)(row0 + ai * HALF + m * 16) * ldc + col0;
#pragma unroll
                for (int bj = 0; bj < 2; ++bj) { const f32x4 v0 = acc[ai][bj][m][0], v1 = acc[ai][bj][m][1];
                    u32x4 w; w.x = cvt_pk_bf16(v0[0], v0[1]); w.y = cvt_pk_bf16(v0[2], v0[3]); w.z = cvt_pk_bf16(v1[0], v1[1]); w.w = cvt_pk_bf16(v1[2], v1[3]);
                    *(u32x4*)(rowp + bj * HALF) = w; } }
    }
};
struct EpiSwiGLU {
    static constexpr bool PERM = true;
    bf16_t* O; int ldc;
    __device__ __forceinline__ void operator()(const f32x4 (&acc)[2][2][4][2], const Unit& u, int wr, int wc, int fr, int fq) const {
        const int row0 = u.pm * BM + wr * 64 + fr, col0 = u.pn * HALF + wc * 32 + 8 * fq;
#pragma unroll
        for (int ai = 0; ai < 2; ++ai)
#pragma unroll
            for (int m = 0; m < 4; ++m) { bf16_t* rowp = O + (size_t)(row0 + ai * HALF + m * 16) * ldc + col0;
                float r[8];
#pragma unroll
                for (int n = 0; n < 2; ++n)
#pragma unroll
                    for (int j = 0; j < 4; ++j) { const float g = acc[ai][0][m][n][j], up = acc[ai][1][m][n][j]; r[4 * n + j] = g * fast_rcp(1.0f + __expf(-g)) * up; }
                u32x4 w; w.x = cvt_pk_bf16(r[0], r[1]); w.y = cvt_pk_bf16(r[2], r[3]); w.z = cvt_pk_bf16(r[4], r[5]); w.w = cvt_pk_bf16(r[6], r[7]);
                *(u32x4*)rowp = w; }
    }
};
struct EpiLruIn {
    static constexpr bool PERM = true;
    bf16_t* GB; bf16_t* U;
    __device__ __forceinline__ void operator()(const f32x4 (&acc)[2][2][4][2], const Unit& u, int wr, int wc, int fr, int fq) const {
        const bool gate = u.pn < 4;
        bf16_t* base = gate ? GB : U;
        const int row0 = u.pm * BM + wr * 64 + fr, col0 = (u.pn & 3) * BM + wc * 32 + 8 * fq;
#pragma unroll
        for (int ai = 0; ai < 2; ++ai)
#pragma unroll
            for (int m = 0; m < 4; ++m) { bf16_t* rowp = base + (size_t)(row0 + ai * HALF + m * 16) * D + col0;
#pragma unroll
                for (int bj = 0; bj < 2; ++bj) { f32x4 v0 = acc[ai][bj][m][0], v1 = acc[ai][bj][m][1];
                    if (gate) {
#pragma unroll
                        for (int j = 0; j < 4; ++j) { v0[j] = gelu_tanh(v0[j]); v1[j] = gelu_tanh(v1[j]); } }
                    u32x4 w; w.x = cvt_pk_bf16(v0[0], v0[1]); w.y = cvt_pk_bf16(v0[2], v0[3]); w.z = cvt_pk_bf16(v1[0], v1[1]); w.w = cvt_pk_bf16(v1[2], v1[3]);
                    *(u32x4*)(rowp + bj * HALF) = w; } }
    }
};
struct EpiLruGate {
    static constexpr bool PERM = false;
    const bf16_t* UC; const float* ba; const float* bx; const float* lsl; float* LA; float* LB;
    __device__ __forceinline__ void operator()(const f32x4 (&acc)[2][2][4][2], const Unit& u, int wr, int wc, int fr, int fq) const {
        const int row0 = u.pm * BM + wr * 64 + fr, d0 = u.pn * HALF + wc * 32 + 4 * fq;
#pragma unroll
        for (int n = 0; n < 2; ++n) {
            const f32x4 vba = *(const f32x4*)(ba + d0 + 16 * n), vbx = *(const f32x4*)(bx + d0 + 16 * n), vls = *(const f32x4*)(lsl + d0 + 16 * n);
#pragma unroll
            for (int ai = 0; ai < 2; ++ai)
#pragma unroll
                for (int m = 0; m < 4; ++m) { const size_t ro = (size_t)(row0 + ai * HALF + m * 16) * D + d0 + 16 * n;
                    const u32x2 ucw = *(const u32x2*)(UC + ro); const float ucv[4] = {bflo(ucw.x), bfhi(ucw.x), bflo(ucw.y), bfhi(ucw.y)};
                    f32x4 av, bv;
#pragma unroll
                    for (int j = 0; j < 4; ++j) { const float r = sigmoid_f(acc[ai][0][m][n][j] + vba[j]), ig = sigmoid_f(acc[ai][1][m][n][j] + vbx[j]);
                        const float la = vls[j] * r, a = __expf(la), x2 = 2.0f * la;
                        const float small = -x2 * (1.0f + 0.5f * x2 * (1.0f + (1.0f / 3.0f) * x2 * (1.0f + 0.25f * x2 * (1.0f + 0.2f * x2))));
                        const float om = (x2 > -0.1f) ? small : (1.0f - a * a);
                        av[j] = a; bv[j] = sqrtf(fmaxf(om, 0.f)) * ig * ucv[j]; }
                    *(f32x4*)(LA + ro) = av; *(f32x4*)(LB + ro) = bv;
                    if (m & 1) asm volatile("" ::: "memory"); }
        }
    }
};

template <class Epi, class Sched>
__device__ __forceinline__ void gemm_phase(LAS unsigned char* lds, const Gemm g, const Sched& S, const Epi& E, const int tid) {
    const int wid = __builtin_amdgcn_readfirstlane(tid >> 6), lane = tid & 63, wr = wid >> 2, wc = wid & 3, fr = lane & 15, fq = lane >> 4;
    const int K = g.K, nt = K / BK;
    unsigned voffA[2], voffB[2];
#pragma unroll
    for (int i = 0; i < 2; ++i) { int R, C; stage_rc(tid * 16 + i * 8192, R, C); const int Rb = Epi::PERM ? ((R & ~31) + perm32(R & 31)) : R;
        voffA[i] = (unsigned)(R * g.lda + C) * 2u; voffB[i] = (unsigned)(Rb * g.ldb + C) * 2u; }
    const size_t kstep = (size_t)(BK * 2);
    const size_t hstepA = (size_t)HALF * g.lda * 2, hstepB = (size_t)HALF * g.ldb * 2;
    const unsigned ldsw = (unsigned)wid * 1024u;
    const int aoff = lds_byte(wr * 64 + fr, fq * 8), boff = lds_byte(wc * 32 + fr, fq * 8);
#define PG8_ABASE(u) ((const char*)g.A + ((size_t)(u).pm * BM * g.lda + (g.ablk ? (size_t)((u).pn / g.ablk) * K : (size_t)0)) * 2)
#define PG8_BBASE(u) ((const char*)g.Bt + (size_t)(u).pn * BM * g.ldb * 2)
#define PG8_SA(b, h) (((b) * 2 + (h)) * HTB)
#define PG8_SB(b, h) ((4 + (b) * 2 + (h)) * HTB)
#define PG8_STAGE(bufoff, gbase, voff) do { _Pragma("unroll") for (int _i = 0; _i < 2; ++_i) \
        __builtin_amdgcn_global_load_lds((const unsigned*)((const char*)(gbase) + (voff)[_i]), (LAS unsigned*)(lds + (bufoff) + ldsw + _i * 8192), 16, 0, 0); } while (0)
#define PG8_LDA(dst, b, h) do { _Pragma("unroll") for (int m = 0; m < 4; ++m) _Pragma("unroll") for (int k = 0; k < 2; ++k) dst[m][k] = *(const LAS bf16x8*)(lds + PG8_SA(b, h) + aoff + m * 2048 + k * 1024); } while (0)
#define PG8_LDB(dst, b, h) do { _Pragma("unroll") for (int n = 0; n < 2; ++n) _Pragma("unroll") for (int k = 0; k < 2; ++k) dst[n][k] = *(const LAS bf16x8*)(lds + PG8_SB(b, h) + boff + n * 2048 + k * 1024); } while (0)
#define PG8_MMA(ai, bj, At, Bt) do { __builtin_amdgcn_s_setprio(1); _Pragma("unroll") for (int m = 0; m < 4; ++m) _Pragma("unroll") for (int n = 0; n < 2; ++n) _Pragma("unroll") for (int k = 0; k < 2; ++k) \
        acc[ai][bj][m][n] = __builtin_amdgcn_mfma_f32_16x16x32_bf16(Bt[n][k], At[m][k], acc[ai][bj][m][n], 0, 0, 0); __builtin_amdgcn_s_setprio(0); } while (0)
#define PG8_WAIT_V(n) asm volatile("s_waitcnt vmcnt(" #n ")" ::: "memory")
#define PG8_WAIT_L(n) asm volatile("s_waitcnt lgkmcnt(" #n ")" ::: "memory")
#define PG8_BAR __builtin_amdgcn_s_barrier()
#define PG8_SCHED __builtin_amdgcn_sched_barrier(0)
    Unit cur, nxt; int ui = 0;
    if (!S.next(0, cur)) return;
    f32x4 acc[2][2][4][2];
#pragma unroll
    for (int a = 0; a < 2; ++a)
#pragma unroll
        for (int b = 0; b < 2; ++b)
#pragma unroll
            for (int m = 0; m < 4; ++m)
#pragma unroll
                for (int n = 0; n < 2; ++n) acc[a][b][m][n] = (f32x4){0.f, 0.f, 0.f, 0.f};
    bf16x8 At[4][2], B0[2][2], B1[2][2];
    const char* cA = PG8_ABASE(cur); const char* cB = PG8_BBASE(cur);
    S.a_ready(cur);
    PG8_STAGE(PG8_SB(0, 0), cB, voffB); PG8_STAGE(PG8_SB(0, 1), cB + hstepB, voffB); PG8_STAGE(PG8_SA(0, 0), cA, voffA); PG8_STAGE(PG8_SA(0, 1), cA + hstepA, voffA);
    if (wr == 1) PG8_BAR;
    PG8_WAIT_V(2); PG8_BAR;
    PG8_STAGE(PG8_SB(1, 0), cB + kstep, voffB); PG8_STAGE(PG8_SA(1, 0), cA + kstep, voffA); PG8_STAGE(PG8_SB(1, 1), cB + hstepB + kstep, voffB);
    PG8_WAIT_V(6); PG8_BAR;
    for (;;) {
        const bool has_next = S.next(ui + 1, nxt);
        const char* nA = has_next ? PG8_ABASE(nxt) : cA; const char* nB = has_next ? PG8_BBASE(nxt) : cB;
#pragma nounroll
        for (int t = 0; t < nt; t += 2) {
            const bool last = (t == nt - 2);
            const char* a1 = cA + (size_t)(t + 1) * kstep;
            const char* a2 = last ? nA : cA + (size_t)(t + 2) * kstep; const char* b2 = last ? nB : cB + (size_t)(t + 2) * kstep;
            const char* a3 = a2 + kstep; const char* b3 = b2 + kstep;
            if (last && has_next) S.a_ready(nxt);
            PG8_LDB(B0, 0, 0); PG8_LDB(B1, 0, 1); PG8_SCHED; PG8_LDA(At, 0, 0); PG8_STAGE(PG8_SA(1, 1), a1 + hstepA, voffA);
            PG8_WAIT_V(8); PG8_WAIT_L(0); PG8_BAR; PG8_MMA(0, 0, At, B0); PG8_MMA(0, 1, At, B1); PG8_BAR; PG8_SCHED;
            PG8_LDA(At, 0, 1); PG8_STAGE(PG8_SB(0, 0), b2, voffB); PG8_STAGE(PG8_SB(0, 1), b2 + hstepB, voffB); PG8_STAGE(PG8_SA(0, 0), a2, voffA);
            PG8_WAIT_V(8); PG8_WAIT_L(0); PG8_BAR; PG8_MMA(1, 0, At, B0); PG8_MMA(1, 1, At, B1); PG8_BAR; PG8_SCHED;
            PG8_LDB(B0, 1, 0); PG8_LDB(B1, 1, 1); PG8_SCHED; PG8_LDA(At, 1, 0); PG8_STAGE(PG8_SA(0, 1), a2 + hstepA, voffA);
            PG8_WAIT_V(8); PG8_WAIT_L(0); PG8_BAR; PG8_MMA(0, 0, At, B0); PG8_MMA(0, 1, At, B1); PG8_BAR; PG8_SCHED;
            PG8_LDA(At, 1, 1); PG8_STAGE(PG8_SB(1, 0), b3, voffB); PG8_STAGE(PG8_SB(1, 1), b3 + hstepB, voffB); PG8_STAGE(PG8_SA(1, 0), a3, voffA);
            PG8_WAIT_V(8); PG8_WAIT_L(0); PG8_BAR; PG8_MMA(1, 0, At, B0); PG8_MMA(1, 1, At, B1); PG8_BAR; PG8_SCHED;
        }
        if (wr == 0) PG8_BAR;
        { int fr_ = fr, fq_ = fq; asm volatile("" : "+v"(fr_), "+v"(fq_)); E(acc, cur, wr, wc, fr_, fq_); }
        S.done(cur);
        if (!has_next) break;
#pragma unroll
        for (int a = 0; a < 2; ++a)
#pragma unroll
            for (int b = 0; b < 2; ++b)
#pragma unroll
                for (int m = 0; m < 4; ++m)
#pragma unroll
                    for (int n = 0; n < 2; ++n) acc[a][b][m][n] = (f32x4){0.f, 0.f, 0.f, 0.f};
        cur = nxt; cA = nA; cB = nB; ++ui;
        if (wr == 1) PG8_BAR;
    }
    PG8_WAIT_V(0);
    PG8_BAR;
#undef PG8_ABASE
#undef PG8_BBASE
#undef PG8_SA
#undef PG8_SB
#undef PG8_STAGE
#undef PG8_LDA
#undef PG8_LDB
#undef PG8_MMA
#undef PG8_WAIT_V
#undef PG8_WAIT_L
#undef PG8_BAR
#undef PG8_SCHED
}
}

struct Args { const float* in[21]; float* out; unsigned char* ws; int ph_lo, ph_hi; };
struct Frame {
    LAS unsigned char* lds;
    int tid, lane, wave, vcu, G, bx;
    unsigned char* ws; float* out;
};
#define BLK_SYNC() __syncthreads()

__device__ __forceinline__ void tr_item(const float* W, int ldw, int k0, int col0, bf16_t* dst, int ldd, float scale, LAS float* scr, int lane) {
#pragma unroll 8
    for (int i = 0; i < 32; ++i) { const int kk = 2 * i + (lane >> 5); scr[kk * 33 + (lane & 31)] = W[(size_t)(k0 + kk) * ldw + col0 + (lane & 31)]; }
    asm volatile("s_waitcnt lgkmcnt(0)" ::: "memory");
    const int c = lane & 7;
#pragma unroll
    for (int j = 0; j < 4; ++j) { const int n = (lane >> 3) + 8 * j; const LAS float* s = scr + (8 * c) * 33 + n;
        u32x4 o; o.x = cvt_pk_bf16(s[0 * 33] * scale, s[1 * 33] * scale); o.y = cvt_pk_bf16(s[2 * 33] * scale, s[3 * 33] * scale); o.z = cvt_pk_bf16(s[4 * 33] * scale, s[5 * 33] * scale); o.w = cvt_pk_bf16(s[6 * 33] * scale, s[7 * 33] * scale);
        *(u32x4*)(dst + (size_t)n * ldd + k0 + 8 * c) = o; }
    asm volatile("s_waitcnt lgkmcnt(0)" ::: "memory");
}
__device__ __forceinline__ void norm_row_to_bf16(const float* xrow, const float* g, bf16_t* orow, int lane) {
    const f32x4* xr = (const f32x4*)xrow + lane; const f32x4* gr = (const f32x4*)g + lane;
    f32x4 v[4]; float s = 0.f;
#pragma unroll
    for (int j = 0; j < 4; ++j) { v[j] = xr[64 * j]; s += (v[j].x * v[j].x + v[j].y * v[j].y) + (v[j].z * v[j].z + v[j].w * v[j].w); }
    const float r = rsqrtf(wave_sum(s) * (1.f / D) + EPS);
    u32x2* o8 = (u32x2*)orow + lane;
#pragma unroll
    for (int j = 0; j < 4; ++j) { const f32x4 gg = gr[64 * j]; u32x2 w; w.x = cvt_pk_bf16(v[j].x * r * gg.x, v[j].y * r * gg.y); w.y = cvt_pk_bf16(v[j].z * r * gg.z, v[j].w * r * gg.w); o8[64 * j] = w; }
}
typedef const __attribute__((address_space(4))) Args* ArgP;
__device__ __forceinline__ void p0_prologue(const Frame& F, ArgP A) {
    LAS float* scr = (LAS float*)(F.lds + F.wave * 16384);
    const int gw = F.vcu * NWAVES + F.wave, NGW = F.G * NWAVES;
    bf16_t* Wqkvo = (bf16_t*)(F.ws + WS_WQKVO); bf16_t* Wmlo = (bf16_t*)(F.ws + WS_WMLO); bf16_t* Wlin = (bf16_t*)(F.ws + WS_WLIN); bf16_t* Wlg = (bf16_t*)(F.ws + WS_WLG);
    bf16_t* Wlo = (bf16_t*)(F.ws + WS_WLO); bf16_t* Wgu = (bf16_t*)(F.ws + WS_WGU); bf16_t* Wd = (bf16_t*)(F.ws + WS_WD); bf16_t* Wg = (bf16_t*)(F.ws + WS_WG);
    constexpr int I0 = 16 * 96, I1 = 16 * 32, I2 = 16 * 64, I3 = 16 * 32, I4 = 8 * 32, I5 = 4 * 1408, I6 = 2 * 1408;
    constexpr int NITEMS = I0 + I1 + I2 + I3 + I4 + I5 + I6;
    for (int it = gw; it < NITEMS; it += NGW) {
        int r = it;
        if (r < I0) { const int kb = r / 96, nb = r % 96; tr_item(A->in[1], 3088, 64 * kb, 32 * nb, Wqkvo + (size_t)(32 * nb) * D, D, nb < 16 ? 0.125f : 1.0f, scr, F.lane); continue; } r -= I0;
        if (r < I1) { const int kb = r / 32, nb = r % 32; tr_item(A->in[4], D, 64 * kb, 32 * nb, Wmlo + (size_t)(32 * nb) * D, D, 1.0f, scr, F.lane); continue; } r -= I1;
        if (r < I2) { const int kb = r / 64, nb = r % 64; tr_item(A->in[5], 2 * D, 64 * kb, 32 * nb, Wlin + (size_t)(32 * nb) * D, D, 1.0f, scr, F.lane); continue; } r -= I2;
        if (r < I3) { const int kb = r / 32, nb = r % 32; tr_item(A->in[13], D, 64 * kb, 32 * nb, Wlo + (size_t)(32 * nb) * D, D, 1.0f, scr, F.lane); continue; } r -= I3;
        if (r < I4) { const int mat = r / 32, q = r % 32, kb = q / 8, nb = q % 8, blk = mat >> 1, gate = mat & 1;
            const float* src = (gate ? A->in[10] : A->in[8]) + (size_t)blk * 65536; const int d0 = 32 * nb, pn = d0 >> 7, i = d0 & 127;
            tr_item(src, 256, 64 * kb, d0, Wlg + (size_t)((blk * 2 + pn) * 256 + gate * 128 + i) * 256, 256, 1.0f, scr, F.lane); continue; } r -= I4;
        if (r < I5) { const int mat = r / 1408, q = r % 1408, kb = q / 88, nb = q % 88, L = mat >> 1, which = mat & 1;
            const float* src = (which ? A->in[19] : A->in[18]) + (size_t)L * D * FF; const int c0 = 32 * nb, pn = c0 >> 7, i = c0 & 127;
            tr_item(src, FF, 64 * kb, c0, Wgu + (size_t)L * NGU * D + (size_t)(pn * 256 + which * 128 + i) * D, D, 1.0f, scr, F.lane); continue; } r -= I5;
        { const int L = r / 1408, q = r % 1408, kb = q / 32, nb = q % 32;
            tr_item(A->in[20] + (size_t)L * FF * D, D, 64 * kb, 32 * nb, Wd + (size_t)L * D * FF + (size_t)(32 * nb) * FF, FF, 1.0f, scr, F.lane); }
    }
    for (int e = (F.vcu * NTHREADS + F.tid); e < 16 * D; e += F.G * NTHREADS) { const int j = e & 15, k = e >> 4; const float w = A->in[1][(size_t)k * 3088 + 3072 + j];
        Wg[j * D + k] = (bf16_t)(cvt_pk_bf16(w, 0.f) & 0xffffu); }
    for (int e = (F.vcu * NTHREADS + F.tid); e < D; e += F.G * NTHREADS) ((float*)(F.ws + WS_LSL))[e] = 8.0f * log_sigmoid_f(A->in[12][e]);
    bf16_t* XN = (bf16_t*)(F.ws + WS_XN);
    for (int m = gw; m < M; m += NGW) norm_row_to_bf16(A->in[0] + (size_t)m * D, A->in[14], XN + (size_t)m * D, F.lane);
}

__device__ __forceinline__ void row_pass(const Frame& F, const bf16_t* OUT, const float* hin, float* hout, const float* g_post, const float* g_next, bf16_t* XN) {
    const int gw = F.vcu * NWAVES + F.wave, NGW = F.G * NWAVES, lane = F.lane;
    for (int m = gw; m < M; m += NGW) {
        const u32x2* orow = (const u32x2*)(OUT + (size_t)m * D) + lane; const f32x4* hr = (const f32x4*)(hin + (size_t)m * D) + lane;
        f32x4 o[4], h[4]; float s = 0.f;
#pragma unroll
        for (int j = 0; j < 4; ++j) { const u32x2 w = orow[64 * j]; o[j] = (f32x4){bflo(w.x), bfhi(w.x), bflo(w.y), bfhi(w.y)}; h[j] = hr[64 * j];
            s += (o[j].x * o[j].x + o[j].y * o[j].y) + (o[j].z * o[j].z + o[j].w * o[j].w); }
        const float r = rsqrtf(wave_sum(s) * (1.f / D) + EPS); float s2 = 0.f;
        f32x4* ho = (f32x4*)(hout + (size_t)m * D) + lane;
#pragma unroll
        for (int j = 0; j < 4; ++j) { const f32x4 gp = ((const f32x4*)g_post)[lane + 64 * j]; h[j] = h[j] + o[j] * r * gp; ho[64 * j] = h[j];
            s2 += (h[j].x * h[j].x + h[j].y * h[j].y) + (h[j].z * h[j].z + h[j].w * h[j].w); }
        if (g_next) { const float r2 = rsqrtf(wave_sum(s2) * (1.f / D) + EPS); u32x2* o8 = (u32x2*)(XN + (size_t)m * D) + lane;
#pragma unroll
            for (int j = 0; j < 4; ++j) { const f32x4 gg = ((const f32x4*)g_next)[lane + 64 * j]; u32x2 w; w.x = cvt_pk_bf16(h[j].x * r2 * gg.x, h[j].y * r2 * gg.y); w.y = cvt_pk_bf16(h[j].z * r2 * gg.z, h[j].w * r2 * gg.w); o8[64 * j] = w; } }
    }
}

__device__ __forceinline__ void mlstm_gates(const Frame& F, const float* b_if) {
    const bf16_t* XN = (const bf16_t*)(F.ws + WS_XN); const bf16_t* Wg = (const bf16_t*)(F.ws + WS_WG); float* GATES = (float*)(F.ws + WS_GATES);
    const int gw = F.vcu * NWAVES + F.wave, NGW = F.G * NWAVES, fr = F.lane & 15, fq = F.lane >> 4;
    for (int t = gw; t < M / 16; t += NGW) {
        const bf16_t* xa = XN + (size_t)(t * 16 + fr) * D + fq * 8; const bf16_t* wb = Wg + (size_t)fr * D + fq * 8;
        f32x4 acc = (f32x4){0.f, 0.f, 0.f, 0.f};
#pragma unroll 8
        for (int ks = 0; ks < 32; ++ks) { const bf16x8 xf = *(const bf16x8*)(xa + ks * 32), wf = *(const bf16x8*)(wb + ks * 32); acc = __builtin_amdgcn_mfma_f32_16x16x32_bf16(wf, xf, acc, 0, 0, 0); }
        f32x4 o;
#pragma unroll
        for (int r = 0; r < 4; ++r) { const int j = 4 * fq + r; const float z = acc[r] + b_if[j]; const float c = 15.0f * tanhf(z * (1.0f / 15.0f)); o[r] = (j < 8) ? c : log_sigmoid_f(c); }
        *(f32x4*)(GATES + (size_t)(t * 16 + fr) * 16 + 4 * fq) = o;
    }
}

__device__ __forceinline__ bf16x8 frag_row(const LAS bf16_t* img, int pitch, int idx0, int k0, int lane) { return *(const LAS bf16x8*)(img + (idx0 + (lane & 15)) * pitch + k0 + 8 * (lane >> 4)); }
__device__ __forceinline__ bf16x8 frag_tr(const LAS bf16_t* img, int pitch, int idx0, int k0, int lane) {
    const int i16 = lane & 15, q = i16 >> 2, p = i16 & 3, g = lane >> 4;
    const LAS bf16_t* a = img + (k0 + 8 * g + q) * pitch + idx0 + 4 * p;
    const s16x4 lo = __builtin_amdgcn_ds_read_tr16_b64_v4i16((LAS s16x4*)a), hi = __builtin_amdgcn_ds_read_tr16_b64_v4i16((LAS s16x4*)(a + 4 * pitch));
    return __builtin_shufflevector(lo, hi, 0, 1, 2, 3, 4, 5, 6, 7);
}
__device__ __forceinline__ float wave_incl_scan_sum(float v, int lane) {
#pragma unroll
    for (int o = 1; o < 64; o <<= 1) { const float t = __shfl_up(v, o); if (lane >= o) v += t; }
    return v;
}
__device__ __forceinline__ float wave_incl_scan_max(float v, int lane) {
#pragma unroll
    for (int o = 1; o < 64; o <<= 1) { const float t = __shfl_up(v, o); if (lane >= o) v = fmaxf(v, t); }
    return v;
}

constexpr int KP = 72, VP = 136;
__device__ __forceinline__ void mlstm_local(const Frame& F) {
    const bf16_t* QKVO = (const bf16_t*)(F.ws + WS_RA); const float* GATES = (const float*)(F.ws + WS_GATES);
    bf16_t* CT = (bf16_t*)(F.ws + WS_CT); float* NL = (float*)(F.ws + WS_NL); float* GT = (float*)(F.ws + WS_STAT); float* ML = GT + NUNIT;
    LAS bf16_t* KW = (LAS bf16_t*)F.lds;
    LAS bf16_t* VV = KW + 64 * KP;
    LAS float* wv = (LAS float*)(VV + 64 * VP);
    const int tid = F.tid, lane = F.lane, wave = F.wave, fr = lane & 15, fq = lane >> 4;
    int it = 0;
    for (int unit = F.vcu; unit < NUNIT; unit += F.G, ++it) {
        const int c = unit & 63, h = (unit >> 6) & 7, b = unit >> 9; const size_t row0 = (size_t)b * SEQ + c * 64;
        LAS float* w_ = wv + (it & 1) * 64;
        const u32x4 kr = *(const u32x4*)(QKVO + (row0 + (tid >> 3)) * NQKVO + KOFF + h * 64 + (tid & 7) * 8);
        u32x4 vr[2];
#pragma unroll
        for (int i = 0; i < 2; ++i) vr[i] = *(const u32x4*)(QKVO + (row0 + (tid >> 4) + 32 * i) * NQKVO + VOFF + h * 128 + (tid & 15) * 8);
        if (wave == 0) {
            const float li = GATES[(row0 + lane) * 16 + h], lf = GATES[(row0 + lane) * 16 + 8 + h];
            const float bc = wave_incl_scan_sum(lf, lane), gt = __shfl(bc, 63), a = gt - bc + li, ml = wave_max(a);
            w_[lane] = __expf(a - ml);
            if (lane == 0) { GT[unit] = gt; ML[unit] = ml; }
        }
        BLK_SYNC();
        { const float ws_ = w_[tid >> 3]; u32x4 o;
            o.x = cvt_pk_bf16(bflo(kr.x) * ws_, bfhi(kr.x) * ws_); o.y = cvt_pk_bf16(bflo(kr.y) * ws_, bfhi(kr.y) * ws_); o.z = cvt_pk_bf16(bflo(kr.z) * ws_, bfhi(kr.z) * ws_); o.w = cvt_pk_bf16(bflo(kr.w) * ws_, bfhi(kr.w) * ws_);
            *(LAS u32x4*)(KW + (tid >> 3) * KP + (tid & 7) * 8) = o; }
#pragma unroll
        for (int i = 0; i < 2; ++i) *(LAS u32x4*)(VV + ((tid >> 4) + 32 * i) * VP + (tid & 15) * 8) = vr[i];
        BLK_SYNC();
        bf16x8 vf[2];
#pragma unroll
        for (int ks = 0; ks < 2; ++ks) vf[ks] = frag_tr(VV, VP, 16 * wave, 32 * ks, lane);
        bf16_t* ctrow = CT + ((size_t)unit * 128 + 16 * wave + fr) * 64;
#pragma unroll
        for (int dkt = 0; dkt < 4; ++dkt) { f32x4 acc = (f32x4){0.f, 0.f, 0.f, 0.f};
#pragma unroll
            for (int ks = 0; ks < 2; ++ks) { const bf16x8 kf = frag_tr(KW, KP, 16 * dkt, 32 * ks, lane); acc = __builtin_amdgcn_mfma_f32_16x16x32_bf16(kf, vf[ks], acc, 0, 0, 0); }
            u32x2 o; o.x = cvt_pk_bf16(acc[0], acc[1]); o.y = cvt_pk_bf16(acc[2], acc[3]);
            *(u32x2*)(ctrow + 16 * dkt + 4 * fq) = o; }
        if (tid < 64) { float s = 0.f;
#pragma unroll 8
            for (int ss = 0; ss < 64; ++ss) s += bf2f(KW[ss * KP + tid]);
            NL[(size_t)unit * 64 + tid] = s; }
    }
    BLK_SYNC();
}

__device__ __forceinline__ void mlstm_scan(const Frame& F) {
    bf16_t* CT = (bf16_t*)(F.ws + WS_CT); float* NL = (float*)(F.ws + WS_NL); const float* GT = (const float*)(F.ws + WS_STAT); const float* ML = GT + NUNIT; float* MP = (float*)(F.ws + WS_STAT) + 2 * NUNIT;
    LAS float* dec = (LAS float*)F.lds; LAS float* scl = dec + 64;
    const int tid = F.tid, lane = F.lane;
    for (int item = F.vcu; item < 256; item += F.G) {
        const int bh = item >> 2, quarter = item & 3; const int u0 = bh * 64;
        BLK_SYNC();
        if (F.wave == 0) {
            const float gv = GT[u0 + lane], mlv = ML[u0 + lane]; float m = -1e30f, my_mp = 0.f, my_dec = 0.f, my_scl = 0.f;
#pragma unroll 2
            for (int c = 0; c < 64; ++c) { const float g = __shfl(gv, c), ml = __shfl(mlv, c); const float mn = fmaxf(g + m, ml);
                const float d_ = __expf(g + m - mn), s_ = __expf(ml - mn); if (lane == c) { my_mp = m; my_dec = d_; my_scl = s_; } m = mn; }
            dec[lane] = my_dec; scl[lane] = my_scl; if (quarter == 0) MP[u0 + lane] = my_mp;
        }
        BLK_SYNC();
        { f32x4 st = (f32x4){0.f, 0.f, 0.f, 0.f}; bf16_t* p = CT + (size_t)u0 * 8192 + quarter * 2048 + tid * 4;
            for (int c0 = 0; c0 < 64; c0 += 8) { u32x2 cl[8];
#pragma unroll
                for (int j = 0; j < 8; ++j) cl[j] = *(const u32x2*)(p + (size_t)(c0 + j) * 8192);
#pragma unroll
                for (int j = 0; j < 8; ++j) { u32x2 o; o.x = cvt_pk_bf16(st[0], st[1]); o.y = cvt_pk_bf16(st[2], st[3]); *(u32x2*)(p + (size_t)(c0 + j) * 8192) = o;
                    const float d_ = dec[c0 + j], s_ = scl[c0 + j]; st[0] = d_ * st[0] + s_ * bflo(cl[j].x); st[1] = d_ * st[1] + s_ * bfhi(cl[j].x); st[2] = d_ * st[2] + s_ * bflo(cl[j].y); st[3] = d_ * st[3] + s_ * bfhi(cl[j].y); } } }
        if (quarter == 0 && tid < 64) { float st = 0.f; float* p = NL + (size_t)u0 * 64 + tid;
            for (int c = 0; c < 64; ++c) { const float nl = p[c * 64]; p[c * 64] = st; st = dec[c] * st + scl[c] * nl; } }
    }
    BLK_SYNC();
}

__device__ __forceinline__ void mlstm_out(const Frame& F, const float* head_norm) {
    const bf16_t* QKVO = (const bf16_t*)(F.ws + WS_RA); const float* GATES = (const float*)(F.ws + WS_GATES);
    const bf16_t* CT = (const bf16_t*)(F.ws + WS_CT); const float* NP = (const float*)(F.ws + WS_NL); const float* MP = (const float*)(F.ws + WS_STAT) + 2 * NUNIT; bf16_t* Y = (bf16_t*)(F.ws + WS_Y);
    LAS bf16_t* Qs = (LAS bf16_t*)F.lds;
    LAS bf16_t* Ks = Qs + 64 * KP;
    LAS bf16_t* Vs = Ks + 64 * KP;
    LAS bf16_t* Cs = Vs + 64 * VP;
    LAS bf16_t* Ps = Cs + 128 * KP;
    LAS float* fb = (LAS float*)(Ps + 64 * KP);
    const int tid = F.tid, lane = F.lane, wave = F.wave, fr = lane & 15, fq = lane >> 4;
    int it = 0;
    for (int unit = F.vcu; unit < NUNIT; unit += F.G, ++it) {
        const int c = unit & 63, h = (unit >> 6) & 7, b = unit >> 9; const size_t row0 = (size_t)b * SEQ + c * 64;
        LAS float* f_ = fb + (it & 1) * (6 * 64 + 8 * 64);
        LAS float* u_ = f_; LAS float* z_ = f_ + 64; LAS float* wi_ = f_ + 128; LAS float* en_ = f_ + 192; LAS float* inv_ = f_ + 256; LAS float* nn_ = f_ + 320; LAS float* hss_ = f_ + 384;
        { const size_t ro = (row0 + (tid >> 3)) * NQKVO + (tid & 7) * 8;
            const u32x4 qr = *(const u32x4*)(QKVO + ro + QOFF + h * 64), kr = *(const u32x4*)(QKVO + ro + KOFF + h * 64);
            u32x4 vr[2], cr[2];
#pragma unroll
            for (int i = 0; i < 2; ++i) { vr[i] = *(const u32x4*)(QKVO + (row0 + (tid >> 4) + 32 * i) * NQKVO + VOFF + h * 128 + (tid & 15) * 8); cr[i] = *(const u32x4*)(CT + (size_t)unit * 8192 + ((tid >> 3) + 64 * i) * 64 + (tid & 7) * 8); }
            *(LAS u32x4*)(Qs + (tid >> 3) * KP + (tid & 7) * 8) = qr; *(LAS u32x4*)(Ks + (tid >> 3) * KP + (tid & 7) * 8) = kr;
#pragma unroll
            for (int i = 0; i < 2; ++i) { *(LAS u32x4*)(Vs + ((tid >> 4) + 32 * i) * VP + (tid & 15) * 8) = vr[i]; *(LAS u32x4*)(Cs + ((tid >> 3) + 64 * i) * KP + (tid & 7) * 8) = cr[i]; } }
        if (wave == 0) {
            const float li = GATES[(row0 + lane) * 16 + h], lf = GATES[(row0 + lane) * 16 + 8 + h], mp = MP[unit];
            const float bc = wave_incl_scan_sum(lf, lane), uu = li - bc, cm = wave_incl_scan_max(uu, lane), zz = fmaxf(cm, mp);
            u_[lane] = uu; z_[lane] = zz; wi_[lane] = __expf(mp - zz); en_[lane] = __expf(-(bc + zz));
        } else if (wave == 1) nn_[lane] = NP[(size_t)unit * 64 + lane];
        BLK_SYNC();
        for (int ti = wave; ti < 16; ti += 8) { const int tt = ti >> 2, st = ti & 3;
            u32x2 o; o.x = 0u; o.y = 0u;
            if (st <= tt) { f32x4 acc = (f32x4){0.f, 0.f, 0.f, 0.f};
#pragma unroll
                for (int ks = 0; ks < 2; ++ks) acc = __builtin_amdgcn_mfma_f32_16x16x32_bf16(frag_row(Ks, KP, 16 * st, 32 * ks, lane), frag_row(Qs, KP, 16 * tt, 32 * ks, lane), acc, 0, 0, 0);
                const int t = 16 * tt + fr, s0 = 16 * st + 4 * fq; const float zt = z_[t]; float p[4];
#pragma unroll
                for (int r = 0; r < 4; ++r) p[r] = (s0 + r <= t) ? __expf(fminf(u_[s0 + r] - zt, 0.f)) * acc[r] : 0.f;
                o.x = cvt_pk_bf16(p[0], p[1]); o.y = cvt_pk_bf16(p[2], p[3]); }
            *(LAS u32x2*)(Ps + (16 * tt + fr) * KP + 16 * st + 4 * fq) = o; }
        BLK_SYNC();
        if (wave == 0) { float rs = 0.f, qn = 0.f;
#pragma unroll 8
            for (int s = 0; s < 64; ++s) { rs += bf2f(Ps[lane * KP + s]); qn += bf2f(Qs[lane * KP + s]) * nn_[s]; }
            const float den = fmaxf(fabsf(rs + wi_[lane] * qn), en_[lane]); inv_[lane] = 1.0f / den; }
        f32x4 a1[4], a2[4];
        { bf16x8 vf[2], cf[2];
#pragma unroll
            for (int ks = 0; ks < 2; ++ks) { vf[ks] = frag_tr(Vs, VP, 16 * wave, 32 * ks, lane); cf[ks] = frag_row(Cs, KP, 16 * wave, 32 * ks, lane); }
#pragma unroll
            for (int tt = 0; tt < 4; ++tt) { a1[tt] = (f32x4){0.f, 0.f, 0.f, 0.f}; a2[tt] = (f32x4){0.f, 0.f, 0.f, 0.f};
#pragma unroll
                for (int ks = 0; ks < 2; ++ks) { a1[tt] = __builtin_amdgcn_mfma_f32_16x16x32_bf16(vf[ks], frag_row(Ps, KP, 16 * tt, 32 * ks, lane), a1[tt], 0, 0, 0);
                    a2[tt] = __builtin_amdgcn_mfma_f32_16x16x32_bf16(cf[ks], frag_row(Qs, KP, 16 * tt, 32 * ks, lane), a2[tt], 0, 0, 0); } } }
        u32x2 og[4];
#pragma unroll
        for (int tt = 0; tt < 4; ++tt) og[tt] = *(const u32x2*)(QKVO + (row0 + 16 * tt + fr) * NQKVO + OOFF + h * 128 + 16 * wave + 4 * fq);
        BLK_SYNC();
#pragma unroll
        for (int tt = 0; tt < 4; ++tt) { const int t = 16 * tt + fr; const float wi = wi_[t], iv = inv_[t]; float ss = 0.f;
#pragma unroll
            for (int r = 0; r < 4; ++r) { const float hv = (a1[tt][r] + wi * a2[tt][r]) * iv; a1[tt][r] = hv; ss += hv * hv; }
            ss += __shfl_xor(ss, 16); ss += __shfl_xor(ss, 32);
            if (fq == 0) hss_[wave * 64 + t] = ss; }
        BLK_SYNC();
        const f32x4 hn = *(const f32x4*)(head_norm + h * 128 + 16 * wave + 4 * fq);
#pragma unroll
        for (int tt = 0; tt < 4; ++tt) { const int t = 16 * tt + fr; float tot = 0.f;
#pragma unroll
            for (int w = 0; w < 8; ++w) tot += hss_[w * 64 + t];
            const float rn = rsqrtf(tot * (1.0f / 128.0f) + EPS);
            const float o0 = bflo(og[tt].x), o1 = bfhi(og[tt].x), o2 = bflo(og[tt].y), o3 = bfhi(og[tt].y);
            u32x2 w_; w_.x = cvt_pk_bf16(a1[tt][0] * rn * hn[0] * sigmoid_f(o0), a1[tt][1] * rn * hn[1] * sigmoid_f(o1)); w_.y = cvt_pk_bf16(a1[tt][2] * rn * hn[2] * sigmoid_f(o2), a1[tt][3] * rn * hn[3] * sigmoid_f(o3));
            *(u32x2*)(Y + (row0 + t) * D + h * 128 + 16 * wave + 4 * fq) = w_; }
    }
    BLK_SYNC();
}

__device__ __forceinline__ void lru_conv(const Frame& F, const float* cw, const float* cb) {
    const bf16_t* U = (const bf16_t*)(F.ws + WS_U); bf16_t* UC = (bf16_t*)(F.ws + WS_UC);
    for (int task = F.vcu * NTHREADS + F.tid; task < 128 * 1024; task += F.G * NTHREADS) {
        const int g8 = task & 127, seg = task >> 7; const int ch = g8 * 8; const size_t row0 = (size_t)seg * 32; const int t0 = (int)(row0 & (SEQ - 1));
        float w[4][8], bs[8];
#pragma unroll
        for (int j = 0; j < 4; ++j) { const f32x4 a = *(const f32x4*)(cw + j * D + ch), b = *(const f32x4*)(cw + j * D + ch + 4);
#pragma unroll
            for (int e = 0; e < 4; ++e) { w[j][e] = a[e]; w[j][4 + e] = b[e]; } }
        { const f32x4 a = *(const f32x4*)(cb + ch), b = *(const f32x4*)(cb + ch + 4);
#pragma unroll
            for (int e = 0; e < 4; ++e) { bs[e] = a[e]; bs[4 + e] = b[e]; } }
        u32x4 r0 = (u32x4){0u, 0u, 0u, 0u}, r1 = r0, r2 = r0;
        if (t0 > 0) { r0 = *(const u32x4*)(U + (row0 - 3) * D + ch); r1 = *(const u32x4*)(U + (row0 - 2) * D + ch); r2 = *(const u32x4*)(U + (row0 - 1) * D + ch); }
#pragma unroll 4
        for (int i = 0; i < 32; ++i) { const u32x4 r3 = *(const u32x4*)(U + (row0 + i) * D + ch); float o[8];
#pragma unroll
            for (int e = 0; e < 4; ++e) { o[2 * e] = bs[2 * e] + w[0][2 * e] * bflo(r0[e]) + w[1][2 * e] * bflo(r1[e]) + w[2][2 * e] * bflo(r2[e]) + w[3][2 * e] * bflo(r3[e]);
                o[2 * e + 1] = bs[2 * e + 1] + w[0][2 * e + 1] * bfhi(r0[e]) + w[1][2 * e + 1] * bfhi(r1[e]) + w[2][2 * e + 1] * bfhi(r2[e]) + w[3][2 * e + 1] * bfhi(r3[e]); }
            u32x4 ow; ow.x = cvt_pk_bf16(o[0], o[1]); ow.y = cvt_pk_bf16(o[2], o[3]); ow.z = cvt_pk_bf16(o[4], o[5]); ow.w = cvt_pk_bf16(o[6], o[7]);
            *(u32x4*)(UC + (row0 + i) * D + ch) = ow; r0 = r1; r1 = r2; r2 = r3; }
    }
}

__device__ __forceinline__ void lru_scan_local(const Frame& F) {
    const float* LA = (const float*)(F.ws + WS_LA); const float* LB = (const float*)(F.ws + WS_LB); float* AGA = (float*)(F.ws + WS_AGGA); float* AGH = (float*)(F.ws + WS_AGGH);
    for (int task = F.vcu * NTHREADS + F.tid; task < 512 * 256; task += F.G * NTHREADS) {
        const int c4 = task & 255, sg = task >> 8;
        const size_t base = (size_t)sg * 64 * D + c4 * 4; f32x4 P = (f32x4){1.f, 1.f, 1.f, 1.f}, Hh = (f32x4){0.f, 0.f, 0.f, 0.f};
#pragma unroll 8
        for (int i = 0; i < 64; ++i) { const f32x4 a = *(const f32x4*)(LA + base + (size_t)i * D), bb = *(const f32x4*)(LB + base + (size_t)i * D); Hh = a * Hh + bb; P = P * a; }
        *(f32x4*)(AGA + (size_t)sg * D + c4 * 4) = P; *(f32x4*)(AGH + (size_t)sg * D + c4 * 4) = Hh;
    }
}
__device__ __forceinline__ void lru_scan_final(const Frame& F) {
    const float* LA = (const float*)(F.ws + WS_LA); const float* LB = (const float*)(F.ws + WS_LB); const float* AGA = (const float*)(F.ws + WS_AGGA); const float* AGH = (const float*)(F.ws + WS_AGGH);
    bf16_t* GB = (bf16_t*)(F.ws + WS_RA);
    for (int task = F.vcu * NTHREADS + F.tid; task < 512 * 256; task += F.G * NTHREADS) {
        const int c4 = task & 255, sg = task >> 8, seg = sg & 63, sg0 = sg - seg;
        f32x4 Hh = (f32x4){0.f, 0.f, 0.f, 0.f};
        for (int s = 0; s < seg; ++s) { const f32x4 a = *(const f32x4*)(AGA + (size_t)(sg0 + s) * D + c4 * 4), hh = *(const f32x4*)(AGH + (size_t)(sg0 + s) * D + c4 * 4); Hh = a * Hh + hh; }
        const size_t base = (size_t)sg * 64 * D + c4 * 4;
#pragma unroll 8
        for (int i = 0; i < 64; ++i) { const f32x4 a = *(const f32x4*)(LA + base + (size_t)i * D), bb = *(const f32x4*)(LB + base + (size_t)i * D); Hh = a * Hh + bb;
            u32x2* gp = (u32x2*)(GB + base + (size_t)i * D); const u32x2 g = *gp; u32x2 o; o.x = cvt_pk_bf16(Hh[0] * bflo(g.x), Hh[1] * bfhi(g.x)); o.y = cvt_pk_bf16(Hh[2] * bflo(g.y), Hh[3] * bfhi(g.y)); *gp = o; }
    }
}

constexpr int NPHASES = 20;
template <int PH> __device__ __forceinline__ void run_phase(const Frame& F, ArgP ap) {
    unsigned char* ws = F.ws;
    bf16_t* XN = (bf16_t*)(ws + WS_XN); bf16_t* OUTB = (bf16_t*)(ws + WS_OUT);
    if constexpr (PH == 0) p0_prologue(F, ap);
    else if constexpr (PH == 1 || PH == 5 || PH == 8 || PH == 15 || PH == 18) {
        pg8::Gemm g; pg8::EpiBf16 E;
        if constexpr (PH == 1)       { g = pg8::Gemm{XN, (const bf16_t*)(ws + WS_WQKVO), M, NQKVO, D, D, D, 0}; E = pg8::EpiBf16{(bf16_t*)(ws + WS_RA), NQKVO}; }
        else if constexpr (PH == 5)  { g = pg8::Gemm{(const bf16_t*)(ws + WS_Y), (const bf16_t*)(ws + WS_WMLO), M, D, D, D, D, 0}; E = pg8::EpiBf16{OUTB, D}; }
        else if constexpr (PH == 8)  { g = pg8::Gemm{(const bf16_t*)(ws + WS_RA), (const bf16_t*)(ws + WS_WD), M, D, FF, FF, FF, 0}; E = pg8::EpiBf16{OUTB, D}; }
        else if constexpr (PH == 15) { g = pg8::Gemm{(const bf16_t*)(ws + WS_RA), (const bf16_t*)(ws + WS_WLO), M, D, D, D, D, 0}; E = pg8::EpiBf16{(bf16_t*)(ws + WS_UC), D}; }
        else                         { g = pg8::Gemm{(const bf16_t*)(ws + WS_RA), (const bf16_t*)(ws + WS_WD) + (size_t)D * FF, M, D, FF, FF, FF, 0}; E = pg8::EpiBf16{OUTB, D}; }
        pg8::StaticOrder S; S.init(g.M, g.N, F.G, F.bx);
        pg8::gemm_phase<pg8::EpiBf16, pg8::StaticOrder>(F.lds, g, S, E, F.tid);
        if constexpr (PH == 1) mlstm_gates(F, ap->in[2]);
    }
    else if constexpr (PH == 2) mlstm_local(F);
    else if constexpr (PH == 3) mlstm_scan(F);
    else if constexpr (PH == 4) mlstm_out(F, ap->in[3]);
    else if constexpr (PH == 6)  row_pass(F, OUTB, ap->in[0], F.out, ap->in[15], ap->in[16], XN);
    else if constexpr (PH == 9)  row_pass(F, OUTB, F.out, F.out, ap->in[17], ap->in[14] + D, XN);
    else if constexpr (PH == 16) row_pass(F, (const bf16_t*)(ws + WS_UC), F.out, F.out, ap->in[15] + D, ap->in[16] + D, XN);
    else if constexpr (PH == 19) row_pass(F, OUTB, F.out, F.out, ap->in[17] + D, nullptr, XN);
    else if constexpr (PH == 7 || PH == 17) {
        constexpr int L = (PH == 17);
        pg8::Gemm g{XN, (const bf16_t*)(ws + WS_WGU) + (size_t)L * NGU * D, M, NGU, D, D, D, 0}; pg8::EpiSwiGLU E{(bf16_t*)(ws + WS_RA), FF};
        pg8::StaticOrder S; S.init(g.M, g.N, F.G, F.bx);
        pg8::gemm_phase<pg8::EpiSwiGLU, pg8::StaticOrder>(F.lds, g, S, E, F.tid);
    }
    else if constexpr (PH == 10) {
        pg8::Gemm g{XN, (const bf16_t*)(ws + WS_WLIN), M, 2 * D, D, D, D, 0}; pg8::EpiLruIn E{(bf16_t*)(ws + WS_RA), (bf16_t*)(ws + WS_U)};
        pg8::StaticOrder S; S.init(g.M, g.N, F.G, F.bx);
        pg8::gemm_phase<pg8::EpiLruIn, pg8::StaticOrder>(F.lds, g, S, E, F.tid);
    }
    else if constexpr (PH == 11) lru_conv(F, ap->in[6], ap->in[7]);
    else if constexpr (PH == 12) {
        pg8::Gemm g{(const bf16_t*)(ws + WS_UC), (const bf16_t*)(ws + WS_WLG), M, 8 * 256, 256, D, 256, 2};
        pg8::EpiLruGate E{(const bf16_t*)(ws + WS_UC), ap->in[9], ap->in[11], (const float*)(ws + WS_LSL), (float*)(ws + WS_LA), (float*)(ws + WS_LB)};
        pg8::StaticOrder S; S.init(g.M, g.N, F.G, F.bx);
        pg8::gemm_phase<pg8::EpiLruGate, pg8::StaticOrder>(F.lds, g, S, E, F.tid);
    }
    else if constexpr (PH == 13) lru_scan_local(F);
    else if constexpr (PH == 14) lru_scan_final(F);
}
__global__ void __launch_bounds__(NTHREADS, 2) trunk_fwd(Args args) {
    extern __shared__ __attribute__((aligned(16))) unsigned char lds_raw[];
    const int lo = args.ph_lo, hi = args.ph_hi;
#if MK_ONE_LAUNCH
#define SEAM(k) if ((k) + 1 < hi) { cg::this_grid().sync(); }
#else
#define SEAM(k)
#endif
#define STEP(k) if (lo <= (k) && (k) < hi) { \
        Frame F; ArgP ap = (ArgP)__builtin_amdgcn_kernarg_segment_ptr(); int tid_ = threadIdx.x, G_ = gridDim.x, bx_ = blockIdx.x; \
        asm volatile("" : "+s"(ap), "+v"(tid_), "+s"(G_), "+s"(bx_)); \
        F.lds = (LAS unsigned char*)lds_raw; F.tid = tid_; F.lane = tid_ & 63; F.wave = __builtin_amdgcn_readfirstlane(tid_ >> 6); \
        F.G = G_; F.vcu = (G_ % 8 == 0) ? (bx_ % 8) * (G_ / 8) + bx_ / 8 : bx_; F.bx = bx_; F.ws = ap->ws; F.out = ap->out; \
        run_phase<k>(F, ap); SEAM(k) }
    STEP(0) STEP(1) STEP(2) STEP(3) STEP(4) STEP(5) STEP(6) STEP(7) STEP(8) STEP(9)
    STEP(10) STEP(11) STEP(12) STEP(13) STEP(14) STEP(15) STEP(16) STEP(17) STEP(18) STEP(19)
#undef STEP
#undef SEAM
}

#ifndef MK_DIAG
#define MK_DIAG 0
#endif
#if MK_DIAG
__global__ void diag_chk(const void* buf, size_t n, int is_bf16, unsigned* flags, int phase) {
    bool bad = false;
    for (size_t i = (size_t)blockIdx.x * blockDim.x + threadIdx.x; i < n; i += (size_t)gridDim.x * blockDim.x) {
        if (is_bf16) { const unsigned v = ((const unsigned short*)buf)[i]; bad |= (v & 0x7f80u) == 0x7f80u; }
        else { const unsigned v = ((const unsigned*)buf)[i]; bad |= (v & 0x7f800000u) == 0x7f800000u; } }
    if (bad) atomicOr(flags, 1u << phase);
}
__global__ void diag_fin(float* out, size_t n, const unsigned* flags) {
    for (size_t i = (size_t)blockIdx.x * blockDim.x + threadIdx.x; i < n; i += (size_t)gridDim.x * blockDim.x) { const unsigned v = __float_as_uint(out[i]); if ((v & 0x7f800000u) == 0x7f800000u) out[i] = 0.f; }
    if (blockIdx.x == 0 && threadIdx.x == 0) { const unsigned f = *flags; if (f) out[0] = (10.0f + (float)(f & 63u)) * 1000.0f; }
}
#endif
extern "C" void kernel_launch(void* const* d_in, const int* in_sizes, int n_in, void* d_out, int out_size, void* d_ws, size_t ws_size, hipStream_t stream) {
    static int grid = 0;
    if (grid == 0) {
        if (n_in != 21 || in_sizes[0] != M * D || out_size != M * D || ws_size < WS_END) { fprintf(stderr, "kernel_launch: unexpected shapes: n_in %d in0 %d out %d ws %zu\n", n_in, n_in > 0 ? in_sizes[0] : -1, out_size, ws_size); grid = -1; return; }
        int dev = 0, cus = 0, per_cu = 0;
        if (hipGetDevice(&dev) != hipSuccess || hipDeviceGetAttribute(&cus, hipDeviceAttributeMultiprocessorCount, dev) != hipSuccess) { grid = -1; return; }
        if (hipFuncSetAttribute((const void*)trunk_fwd, hipFuncAttributeMaxDynamicSharedMemorySize, LDS_BYTES) != hipSuccess) { fprintf(stderr, "kernel_launch: hipFuncSetAttribute failed\n"); grid = -1; return; }
        if (hipOccupancyMaxActiveBlocksPerMultiprocessor(&per_cu, (const void*)trunk_fwd, NTHREADS, LDS_BYTES) != hipSuccess || per_cu < 1) { fprintf(stderr, "kernel_launch: occupancy query says %d\n", per_cu); (void)hipGetLastError(); grid = -1; return; }
        grid = cus;
        fprintf(stderr, "kernel_launch: grid %d (per_cu %d), ws %zu\n", grid, per_cu, ws_size);
    }
    if (grid < 0) return;
    Args a{};
    for (int i = 0; i < 21; ++i) a.in[i] = (const float*)d_in[i];
    a.out = (float*)d_out; a.ws = (unsigned char*)d_ws;
#if MK_ONE_LAUNCH
    a.ph_lo = 0; a.ph_hi = NPHASES;
    void* kargs[] = {&a};
    hipError_t e = hipLaunchCooperativeKernel((const void*)trunk_fwd, dim3(grid), dim3(NTHREADS), kargs, LDS_BYTES, stream);
    if (e != hipSuccess) fprintf(stderr, "cooperative launch failed: %s (grid %d)\n", hipGetErrorString(e), grid);
#else
#if MK_DIAG
    unsigned char* w8 = (unsigned char*)d_ws; unsigned* flags = (unsigned*)w8;
    hipMemsetAsync(flags, 0, 256, stream);
    hipMemsetAsync(w8 + WS_NL, 0xAA, 2 * MiB, stream); hipMemsetAsync(w8 + WS_CT, 0xAA, 64 * MiB, stream);
#define CHK(off, n, bf, ph) hipLaunchKernelGGL(diag_chk, dim3(1024), dim3(256), 0, stream, (const void*)(w8 + (off)), (size_t)(n), (bf), flags, (ph))
#endif
    for (int ph = 0; ph < NPHASES; ++ph) { a.ph_lo = ph; a.ph_hi = ph + 1; hipLaunchKernelGGL(trunk_fwd, dim3(grid), dim3(NTHREADS), LDS_BYTES, stream, a);
#if MK_DIAG
        const size_t MD = (size_t)M * D;
        switch (ph < 4 ? ph : 99) {
        case 0: CHK(WS_WQKVO, (WS_GATES - WS_WQKVO) / 2, 1, ph); CHK(WS_XN, MD, 1, ph); CHK(WS_LSL, D, 0, ph); break;
        case 1: CHK(WS_RA, (size_t)M * NQKVO, 1, ph); CHK(WS_GATES, (size_t)M * 16, 0, ph); break;
        case 2: CHK(WS_CT, (size_t)NUNIT * 8192, 1, 0); CHK(WS_NL, (size_t)NUNIT * 64, 0, 1); CHK(WS_STAT, (size_t)2 * NUNIT, 0, 2); break;
        case 3: CHK(WS_CT, (size_t)NUNIT * 8192, 1, 3); CHK(WS_NL, (size_t)NUNIT * 64, 0, 4); CHK(WS_STAT + 8 * NUNIT, (size_t)NUNIT, 0, 5); break;
        case 4: CHK(WS_Y, MD, 1, ph); break;
        case 5: case 8: case 18: CHK(WS_OUT, MD, 1, ph); break;
        case 6: case 9: case 16: CHK(WS_XN, MD, 1, ph); hipLaunchKernelGGL(diag_chk, dim3(1024), dim3(256), 0, stream, (const void*)d_out, MD, 0, flags, ph); break;
        case 7: case 17: CHK(WS_RA, (size_t)M * FF, 1, ph); break;
        case 10: CHK(WS_RA, MD, 1, ph); CHK(WS_U, MD, 1, ph); break;
        case 11: CHK(WS_UC, MD, 1, ph); break;
        case 12: CHK(WS_LA, MD, 0, ph); CHK(WS_LB, MD, 0, ph); break;
        case 13: CHK(WS_AGGA, (size_t)512 * D, 0, ph); CHK(WS_AGGH, (size_t)512 * D, 0, ph); break;
        case 14: CHK(WS_RA, MD, 1, ph); break;
        case 15: CHK(WS_UC, MD, 1, ph); break;
        default: break;
        }
#endif
    }
#if MK_DIAG
    hipLaunchKernelGGL(diag_fin, dim3(1024), dim3(256), 0, stream, (float*)d_out, (size_t)M * D, flags);
#endif
#endif
}
```
